# Optimizing an MI355X kernel written in HIP

```python
import math
import jax, jax.numpy as jnp
from jax import lax
import numpy as np

D_MODEL = 2048
BATCH = 4
SEQ = 2048
DEPTH = 1

CHUNK = 64
Q_BLOCK = 128
SB_HEADS = 8
SB_HEAD_DIM = 128
D_SB = SB_HEADS * SB_HEAD_DIM
D_CONV = D_MODEL // 2
CONV_WIDTH = 31
D_FF = 4 * D_MODEL
EPS = 1e-6
IN_SPLITS = (D_SB, D_SB, D_SB, D_CONV, D_CONV, D_MODEL, D_MODEL)
D_IN = sum(IN_SPLITS)

kernel_name = "stickbreak_conformer_gated_hybrid"


def rmsnorm(x, g):
    xf = x.astype(jnp.float32)
    y = xf * lax.rsqrt(jnp.mean(xf * xf, axis=-1, keepdims=True) + EPS)
    return (y * g.astype(jnp.float32)).astype(x.dtype)


def layernorm(x, g, b):
    xf = x.astype(jnp.float32)
    mu = jnp.mean(xf, axis=-1, keepdims=True)
    var = jnp.mean(jnp.square(xf - mu), axis=-1, keepdims=True)
    y = (xf - mu) * lax.rsqrt(var + EPS)
    return (y * g.astype(jnp.float32) + b.astype(jnp.float32)).astype(x.dtype)


def stick_breaking_attention(q, k, v):
    b, s, h, dh = q.shape
    scale = 1.0 / math.sqrt(dh)
    outs = []
    for i in range(s // Q_BLOCK):
        t0, t1 = i * Q_BLOCK, (i + 1) * Q_BLOCK
        qb = q[:, t0:t1]
        kb = k[:, :t1]
        vb = v[:, :t1]
        z = jnp.einsum('bqhd,bkhd->bhqk', qb, kb).astype(jnp.float32) * scale
        tq = t0 + jnp.arange(Q_BLOCK)[:, None]
        sk = jnp.arange(t1)[None, :]
        mask = sk < tq
        log_1m = jnp.where(mask, jax.nn.log_sigmoid(-z), 0.0)
        suffix = lax.cumsum(log_1m, axis=3, reverse=True) - log_1m
        a = jnp.where(mask, jnp.exp(jax.nn.log_sigmoid(z) + suffix), 0.0)
        outs.append(jnp.einsum('bhqk,bkhd->bqhd', a.astype(vb.dtype), vb))
    return jnp.concatenate(outs, axis=1)


def causal_depthwise_conv(u, w, bias):
    c = u.shape[-1]
    y = lax.conv_general_dilated(
        u, w.reshape(CONV_WIDTH, 1, c).astype(u.dtype),
        window_strides=(1,), padding=[(CONV_WIDTH - 1, 0)],
        dimension_numbers=('NWC', 'WIO', 'NWC'), feature_group_count=c)
    return y + bias


def setup_inputs(seed: int = 0) -> dict:
    key = jax.random.key(seed)
    ks = jax.random.split(key, 17)
    L = DEPTH
    nrm = lambda k, shape, fan_in: jax.random.normal(k, shape, jnp.float32) * (fan_in ** -0.5)
    gain = lambda k, shape: 1.0 + 0.02 * jax.random.normal(k, shape, jnp.float32)
    small = lambda k, shape: 0.02 * jax.random.normal(k, shape, jnp.float32)
    return {
        "x": jax.random.normal(ks[0], (BATCH, SEQ, D_MODEL), jnp.float32),
        "g_pre_mix": gain(ks[1], (L, D_MODEL)),
        "w_in": nrm(ks[2], (L, D_MODEL, D_IN), D_MODEL),
        "b_in": small(ks[3], (L, D_IN)),
        "w_dw": nrm(ks[4], (L, CONV_WIDTH, D_CONV), CONV_WIDTH),
        "b_dw": small(ks[5], (L, D_CONV)),
        "g_conv_ln": gain(ks[6], (L, D_CONV)),
        "b_conv_ln": small(ks[7], (L, D_CONV)),
        "w_sb_out": nrm(ks[8], (L, D_SB, D_MODEL), D_SB),
        "w_conv_out": nrm(ks[9], (L, D_CONV, D_MODEL), D_CONV),
        "w_o": nrm(ks[10], (L, D_MODEL, D_MODEL), D_MODEL),
        "g_post_mix": gain(ks[11], (L, D_MODEL)),
        "g_pre_mlp": gain(ks[12], (L, D_MODEL)),
        "w_up": nrm(ks[13], (L, D_MODEL, D_FF), D_MODEL),
        "w_down": nrm(ks[14], (L, D_FF, D_MODEL), D_FF),
        "g_post_mlp": gain(ks[15], (L, D_MODEL)),
    }


def reference(x, g_pre_mix, w_in, b_in, w_dw, b_dw, g_conv_ln, b_conv_ln,
              w_sb_out, w_conv_out, w_o, g_post_mix, g_pre_mlp, w_up, w_down,
              g_post_mlp):
    b, s, _ = x.shape
    offs = np.cumsum(IN_SPLITS)[:-1].tolist()
    for l in range(DEPTH):
        h = rmsnorm(x, g_pre_mix[l])
        proj = jnp.einsum('bsd,de->bse', h, w_in[l]) + b_in[l]
        q, k, v, glu_a, glu_b, gate_sb, gate_cv = jnp.split(proj, offs, axis=-1)
        hd = (b, s, SB_HEADS, SB_HEAD_DIM)
        o_sb = stick_breaking_attention(q.reshape(hd), k.reshape(hd), v.reshape(hd))
        o_sb = jnp.einsum('bse,ed->bsd', o_sb.reshape(b, s, D_SB), w_sb_out[l])
        u = glu_a * jax.nn.sigmoid(glu_b)
        u = causal_depthwise_conv(u, w_dw[l], b_dw[l])
        u = jax.nn.silu(layernorm(u, g_conv_ln[l], b_conv_ln[l]))
        o_cv = jnp.einsum('bsc,cd->bsd', u, w_conv_out[l])
        merged = jax.nn.sigmoid(gate_sb) * o_sb + jax.nn.sigmoid(gate_cv) * o_cv
        y = jnp.einsum('bsd,de->bse', merged, w_o[l])
        x = x + rmsnorm(y, g_post_mix[l])
        h = rmsnorm(x, g_pre_mlp[l])
        f = jnp.square(jax.nn.relu(jnp.einsum('bsd,df->bsf', h, w_up[l])))
        f = jnp.einsum('bsf,fd->bsd', f, w_down[l])
        x = x + rmsnorm(f, g_post_mlp[l])
    return x
```

```cpp
#include <hip/hip_runtime.h>
#include <hip/hip_cooperative_groups.h>
#include <cstdio>
#include <cstdint>
#include <utility>
namespace cg = cooperative_groups;
#define MK_N_LAUNCHES 9
namespace pg8 {
#define PG8_LAS __attribute__((address_space(3)))
typedef unsigned short bf16_t;
typedef short bf16x8 __attribute__((ext_vector_type(8)));
typedef float f32x4 __attribute__((ext_vector_type(4)));
typedef unsigned u32x4 __attribute__((ext_vector_type(4)));
constexpr int BM = 256, BK = 64, HALF = 128, HTB = HALF * BK * 2  , STAGE_BYTES = 8 * HTB, NXCD = 8, WGM = 8;

__host__ __device__ __forceinline__ int lds_byte(int r, int c) { const int st = (r >> 4) * 2 + (c >> 5), rr = r & 15, cc = c & 31, ob = rr * 64 + cc * 2; return st * 1024 + (ob ^ (((ob >> 9) & 1) << 5)); }
__host__ __device__ __forceinline__ void stage_rc(int b, int& R, int& C) { const int st = b / 1024, sb = b % 1024, swz = sb ^ (((sb >> 9) & 1) << 5); R = (st >> 1) * 16 + swz / 64; C = (st & 1) * 32 + (swz % 64) / 2; }
__host__ __device__ __forceinline__ int perm32(int rho) { const int n = rho >> 4, i = rho & 15; return 8 * (i >> 2) + 4 * n + (i & 3); }

struct Unit { int pm, pn; };
struct Gemm { const bf16_t* A; const bf16_t* Bt; int M, N, K; };

struct StaticOrder {
    int nM, nN, nwg, G, c;
    __host__ __device__ void init(int M, int N, int G_, int c_) { nM = M / BM; nN = N / BM; nwg = nM * nN; G = G_; c = c_; }
    __host__ __device__ bool next(int i, Unit& u) const {
        const long L = (long)i * G + c; if (L >= nwg) return false;
        int wgid = (int)L; { const int q = nwg / NXCD, r = nwg % NXCD, xcd = wgid % NXCD, off = wgid / NXCD; wgid = (xcd < r ? xcd * (q + 1) : r * (q + 1) + (xcd - r) * q) + off; }
        const int nig = WGM * nN, gid = wgid / nig, fm = gid * WGM, gsz = (nM - fm) < WGM ? (nM - fm) : WGM;
        u.pm = fm + ((wgid % nig) % gsz); u.pn = (wgid % nig) / gsz; return true;
    }
    __device__ __forceinline__ void a_ready(const Unit&) const {}
    __device__ __forceinline__ void done(const Unit&) const {}
};


typedef float f32x2_c __attribute__((ext_vector_type(2))); typedef __bf16 bf16x2_c __attribute__((ext_vector_type(2)));
__device__ __forceinline__ unsigned cvt_pk_bf16(float lo, float hi) { const f32x2_c v = {lo, hi}; const bf16x2_c b = __builtin_convertvector(v, bf16x2_c); return __builtin_bit_cast(unsigned, b); }
__device__ __forceinline__ float sigm(float x) { return __builtin_amdgcn_rcpf(1.0f + __builtin_amdgcn_exp2f(-1.4426950408889634f * x)); }
__device__ __forceinline__ u32x4 pack8(const f32x4 a, const f32x4 b) { u32x4 w; w.x = cvt_pk_bf16(a[0], a[1]); w.y = cvt_pk_bf16(a[2], a[3]); w.z = cvt_pk_bf16(b[0], b[1]); w.w = cvt_pk_bf16(b[2], b[3]); return w; }
__device__ __forceinline__ float bf_lo(unsigned w) { return __builtin_bit_cast(float, w << 16); }
__device__ __forceinline__ float bf_hi(unsigned w) { return __builtin_bit_cast(float, w & 0xffff0000u); }

constexpr float QSCALE = 0.08838834764831845f * 1.4426950408889634f;

struct EpiProj {
    static constexpr bool PERM = true, AFTER_DRAIN = false;
    bf16_t *Qp, *Kp, *Vt, *U, *G; const float* bias;
    __device__ __forceinline__ void operator()(const f32x4 (&acc)[2][2][4][2], const Unit& u, int wr, int wc, int fr, int fq) const {
        const int pn = u.pn; const int rowt = u.pm * BM + wr * 64 + fr;
        if (pn < 8) {
            bf16_t* base = pn < 4 ? Qp : Kp; const float sc = pn < 4 ? QSCALE : 1.0f; const int hp = (pn & 3) * 2;
            const int bcol = pn * BM + wc * 32 + 8 * fq;
#pragma unroll
            for (int bj = 0; bj < 2; ++bj) { const f32x4 b0 = *(const f32x4*)(bias + bcol + bj * HALF), b1 = *(const f32x4*)(bias + bcol + bj * HALF + 4);
#pragma unroll
                for (int ai = 0; ai < 2; ++ai)
#pragma unroll
                    for (int m = 0; m < 4; ++m) { const int row = rowt + ai * HALF + m * 16; const int b = row >> 11, t = row & 2047, blk = t >> 5, rl = t & 31;
                        const size_t idx = ((size_t)((b * 8 + hp + bj) * 64 + blk) << 12) + (size_t)((2 * wc + (fq >> 1)) * 512 + rl * 16 + (fq & 1) * 8);
                        const f32x4 v0 = (acc[ai][bj][m][0] + b0) * sc, v1 = (acc[ai][bj][m][1] + b1) * sc;
                        *(u32x4*)(base + idx) = pack8(v0, v1); } }
        } else if (pn < 12) {
            const int hp = (pn - 8) * 2; const int bcol = pn * BM + wc * 32 + 8 * fq;
#pragma unroll
            for (int bj = 0; bj < 2; ++bj) { const f32x4 b0 = *(const f32x4*)(bias + bcol + bj * HALF), b1 = *(const f32x4*)(bias + bcol + bj * HALF + 4);
#pragma unroll
                for (int ai = 0; ai < 2; ++ai)
#pragma unroll
                    for (int m = 0; m < 4; ++m) { const int row = rowt + ai * HALF + m * 16; const int b = row >> 11, t = row & 2047, blk = t >> 5, kl = t & 31;
                        const int pos16 = ((kl >> 2) & 1) * 8 + ((kl >> 3) & 1) * 4 + (kl & 3);
                        bf16_t* p = Vt + (((size_t)((b * 8 + hp + bj) * 64 + blk) << 12) + (size_t)(wc * 1024 + (kl >> 4) * 512 + (8 * fq) * 16 + pos16));
                        const f32x4 v0 = acc[ai][bj][m][0] + b0, v1 = acc[ai][bj][m][1] + b1;
#pragma unroll
                        for (int j = 0; j < 4; ++j) { p[j * 16] = (bf16_t)(cvt_pk_bf16(v0[j], v0[j]) & 0xffffu); p[(4 + j) * 16] = (bf16_t)(cvt_pk_bf16(v1[j], v1[j]) & 0xffffu); } } }
        } else if (pn < 20) {
            const int col = (pn - 12) * 128 + wc * 32 + 8 * fq;
            const f32x4 a0 = *(const f32x4*)(bias + 3072 + col), a1 = *(const f32x4*)(bias + 3072 + col + 4), g0 = *(const f32x4*)(bias + 4096 + col), g1 = *(const f32x4*)(bias + 4096 + col + 4);
#pragma unroll
            for (int ai = 0; ai < 2; ++ai)
#pragma unroll
                for (int m = 0; m < 4; ++m) { const int row = rowt + ai * HALF + m * 16;
                    const f32x4 x0 = acc[ai][0][m][0] + a0, x1 = acc[ai][0][m][1] + a1, y0 = acc[ai][1][m][0] + g0, y1 = acc[ai][1][m][1] + g1;
                    f32x4 r0, r1;
#pragma unroll
                    for (int j = 0; j < 4; ++j) { r0[j] = x0[j] * sigm(y0[j]); r1[j] = x1[j] * sigm(y1[j]); }
                    *(u32x4*)(U + (size_t)row * 1024 + col) = pack8(r0, r1); }
        } else {
            const int gc = (pn - 20) * BM + wc * 32 + 8 * fq;
#pragma unroll
            for (int bj = 0; bj < 2; ++bj) { const f32x4 b0 = *(const f32x4*)(bias + 5120 + gc + bj * HALF), b1 = *(const f32x4*)(bias + 5120 + gc + bj * HALF + 4);
#pragma unroll
                for (int ai = 0; ai < 2; ++ai)
#pragma unroll
                    for (int m = 0; m < 4; ++m) { const int row = rowt + ai * HALF + m * 16;
                        const f32x4 x0 = acc[ai][bj][m][0] + b0, x1 = acc[ai][bj][m][1] + b1; f32x4 r0, r1;
#pragma unroll
                        for (int j = 0; j < 4; ++j) { r0[j] = sigm(x0[j]); r1[j] = sigm(x1[j]); }
                        *(u32x4*)(G + (size_t)row * 4096 + gc + bj * HALF) = pack8(r0, r1); } }
        }
    }
};

struct EpiDual {
    static constexpr bool PERM = true, AFTER_DRAIN = false;
    const bf16_t* G; float* tmp; bf16_t* merged;
    __device__ __forceinline__ void operator()(const f32x4 (&acc)[2][2][4][2], const Unit& u, int wr, int wc, int fr, int fq) const {
        const bool second = u.pm >= 32; const int rowt = (u.pm & 31) * BM + wr * 64 + fr; const int col = (u.pn & 7) * BM + wc * 32 + 8 * fq; const int gofs = second ? 2048 : 0;
#pragma unroll
        for (int ai = 0; ai < 2; ++ai)
#pragma unroll
            for (int m = 0; m < 4; ++m) { const int row = rowt + ai * HALF + m * 16;
#pragma unroll
                for (int bj = 0; bj < 2; ++bj) { const u32x4 gw = *(const u32x4*)(G + (size_t)row * 4096 + gofs + col + bj * HALF);
                    const f32x4 g0 = {bf_lo(gw.x), bf_hi(gw.x), bf_lo(gw.y), bf_hi(gw.y)}, g1 = {bf_lo(gw.z), bf_hi(gw.z), bf_lo(gw.w), bf_hi(gw.w)};
                    f32x4 v0 = acc[ai][bj][m][0] * g0, v1 = acc[ai][bj][m][1] * g1;
                    float* tp = tmp + (size_t)row * 2048 + col + bj * HALF;
                    if (!second) { *(f32x4*)tp = v0; *(f32x4*)(tp + 4) = v1; }
                    else { v0 += *(const f32x4*)tp; v1 += *(const f32x4*)(tp + 4); *(u32x4*)(merged + (size_t)row * 2048 + col + bj * HALF) = pack8(v0, v1); } } }
    }
};

struct EpiY {
    static constexpr bool PERM = true, AFTER_DRAIN = false;
    float* Y; float* pssq;
    __device__ __forceinline__ void operator()(const f32x4 (&acc)[2][2][4][2], const Unit& u, int wr, int wc, int fr, int fq) const {
        const int rowt = u.pm * BM + wr * 64 + fr; const int col = u.pn * BM + wc * 32 + 8 * fq;
#pragma unroll
        for (int ai = 0; ai < 2; ++ai)
#pragma unroll
            for (int m = 0; m < 4; ++m) { const int row = rowt + ai * HALF + m * 16; float ss = 0.f;
#pragma unroll
                for (int bj = 0; bj < 2; ++bj) { const f32x4 v0 = acc[ai][bj][m][0], v1 = acc[ai][bj][m][1]; float* yp = Y + (size_t)row * 2048 + col + bj * HALF;
                    *(f32x4*)yp = v0; *(f32x4*)(yp + 4) = v1;
                    ss += (v0[0] * v0[0] + v0[1] * v0[1]) + (v0[2] * v0[2] + v0[3] * v0[3]) + (v1[0] * v1[0] + v1[1] * v1[1]) + (v1[2] * v1[2] + v1[3] * v1[3]); }
                ss += __shfl_xor(ss, 16); ss += __shfl_xor(ss, 32);
                if (fq == 0) pssq[(size_t)row * 32 + u.pn * 4 + wc] = ss; }
    }
};

struct EpiUp {
    static constexpr bool PERM = true, AFTER_DRAIN = false;
    bf16_t* F;
    __device__ __forceinline__ void operator()(const f32x4 (&acc)[2][2][4][2], const Unit& u, int wr, int wc, int fr, int fq) const {
        const int rowt = u.pm * BM + wr * 64 + fr; const int col = u.pn * BM + wc * 32 + 8 * fq;
#pragma unroll
        for (int ai = 0; ai < 2; ++ai)
#pragma unroll
            for (int m = 0; m < 4; ++m) { const int row = rowt + ai * HALF + m * 16;
#pragma unroll
                for (int bj = 0; bj < 2; ++bj) { f32x4 v0 = acc[ai][bj][m][0], v1 = acc[ai][bj][m][1];
#pragma unroll
                    for (int j = 0; j < 4; ++j) { const float a = fmaxf(v0[j], 0.f), b = fmaxf(v1[j], 0.f); v0[j] = a * a; v1[j] = b * b; }
                    *(u32x4*)(F + (size_t)row * 8192 + col + bj * HALF) = pack8(v0, v1); } }
    }
};

struct DualOrder {
    StaticOrder b;
    __host__ __device__ void init(int G_, int c_) { b.init(8192, 2048, G_, c_); }
    __host__ __device__ bool next(int i, Unit& u) const { Unit t; if (!b.next(i >> 1, t)) return false; u.pm = t.pm + 32 * (i & 1); u.pn = t.pn + 8 * (i & 1); return true; }
    __device__ __forceinline__ void a_ready(const Unit&) const {}
    __device__ __forceinline__ void done(const Unit&) const {}
};
template <class Epi, class Sched, bool ALIGN_EPI = false, bool SP2 = false>
__device__ __forceinline__ void gemm_phase(PG8_LAS unsigned char* lds, const Gemm g, const Sched& S, const Epi& E) {
    const int tid = threadIdx.x, wid = __builtin_amdgcn_readfirstlane(tid >> 6), lane = tid & 63, wr = wid >> 2, wc = wid & 3, fr = lane & 15, fq = lane >> 4;
    const int K = g.K, nt = K / BK;
    unsigned voffA[2], voffB[2];
#pragma unroll
    for (int i = 0; i < 2; ++i) { int R, C; stage_rc(tid * 16 + i * 8192, R, C); const int Rb = Epi::PERM ? ((R & ~31) + perm32(R & 31)) : R;
        voffA[i] = (unsigned)(R * K + C) * 2u; voffB[i] = (unsigned)(Rb * K + C) * 2u; }
    const size_t kstep = (size_t)(BK * 2);
    const size_t hstep = (size_t)HALF * K * 2;
    const size_t tstep = 2 * hstep;
    const unsigned ldsw = (unsigned)wid * 1024u;
    const int aoff = lds_byte(wr * 64 + fr, fq * 8), boff = lds_byte(wc * 32 + fr, fq * 8);
#define PG8_SA(b, h) (((b) * 2 + (h)) * HTB)
#define PG8_SB(b, h) ((4 + (b) * 2 + (h)) * HTB)
#define PG8_STAGE(bufoff, gbase, voff) do { _Pragma("unroll") for (int _i = 0; _i < 2; ++_i) \
        __builtin_amdgcn_global_load_lds((const unsigned*)((const char*)(gbase) + (voff)[_i]), (PG8_LAS unsigned*)(lds + (bufoff) + ldsw + _i * 8192), 16, 0, 0); } while (0)
#define PG8_LDA(dst, b, h) do { _Pragma("unroll") for (int m = 0; m < 4; ++m) _Pragma("unroll") for (int k = 0; k < 2; ++k) dst[m][k] = *(const PG8_LAS bf16x8*)(lds + PG8_SA(b, h) + aoff + m * 2048 + k * 1024); } while (0)
#define PG8_LDB(dst, b, h) do { _Pragma("unroll") for (int n = 0; n < 2; ++n) _Pragma("unroll") for (int k = 0; k < 2; ++k) dst[n][k] = *(const PG8_LAS bf16x8*)(lds + PG8_SB(b, h) + boff + n * 2048 + k * 1024); } while (0)
#define PG8_MMA(ai, bj, At, Bt) do { __builtin_amdgcn_s_setprio(1); _Pragma("unroll") for (int m = 0; m < 4; ++m) _Pragma("unroll") for (int n = 0; n < 2; ++n) _Pragma("unroll") for (int k = 0; k < 2; ++k) \
        acc[ai][bj][m][n] = __builtin_amdgcn_mfma_f32_16x16x32_bf16(Bt[n][k], At[m][k], acc[ai][bj][m][n], 0, 0, 0); __builtin_amdgcn_s_setprio(0); } while (0)
#define PG8_WAIT_V(n) asm volatile("s_waitcnt vmcnt(" #n ")" ::: "memory")
#define PG8_WAIT_L(n) asm volatile("s_waitcnt lgkmcnt(" #n ")" ::: "memory")
#define PG8_BAR __builtin_amdgcn_s_barrier()
#define PG8_SCHED __builtin_amdgcn_sched_barrier(0)
    Unit cur, nxt; int ui = 0;
    if (!S.next(0, cur)) return;
    f32x4 acc[2][2][4][2];
#pragma unroll
    for (int a = 0; a < 2; ++a)
#pragma unroll
        for (int b = 0; b < 2; ++b)
#pragma unroll
            for (int m = 0; m < 4; ++m)
#pragma unroll
                for (int n = 0; n < 2; ++n) acc[a][b][m][n] = (f32x4){0.f, 0.f, 0.f, 0.f};
    bf16x8 At[4][2], B0[2][2], B1[2][2];
    const char* cA = (const char*)g.A + (size_t)cur.pm * tstep; const char* cB = (const char*)g.Bt + (size_t)cur.pn * tstep;
    S.a_ready(cur);
    if constexpr (SP2) {
        PG8_STAGE(PG8_SB(0, 0), cB, voffB); PG8_STAGE(PG8_SB(0, 1), cB + hstep, voffB); PG8_STAGE(PG8_SA(0, 0), cA, voffA); PG8_STAGE(PG8_SA(0, 1), cA + hstep, voffA);
        if (wr == 1) PG8_BAR;
        PG8_WAIT_V(2); PG8_BAR;
        PG8_STAGE(PG8_SB(1, 0), cB + kstep, voffB); PG8_STAGE(PG8_SA(1, 0), cA + kstep, voffA); PG8_STAGE(PG8_SB(1, 1), cB + hstep + kstep, voffB);
        PG8_WAIT_V(6); PG8_BAR;
    } else {
        PG8_STAGE(PG8_SB(0, 0), cB, voffB); PG8_STAGE(PG8_SA(0, 0), cA, voffA); PG8_STAGE(PG8_SB(0, 1), cB + hstep, voffB); PG8_STAGE(PG8_SA(0, 1), cA + hstep, voffA);
        if (wr == 1) PG8_BAR;
        PG8_WAIT_V(4); PG8_BAR;
        PG8_STAGE(PG8_SB(1, 0), cB + kstep, voffB); PG8_STAGE(PG8_SA(1, 0), cA + kstep, voffA); PG8_STAGE(PG8_SB(1, 1), cB + hstep + kstep, voffB);
        PG8_WAIT_V(6); PG8_BAR;
    }
    for (;;) {
        const bool has_next = S.next(ui + 1, nxt);
        const char* nA = has_next ? (const char*)g.A + (size_t)nxt.pm * tstep : cA; const char* nB = has_next ? (const char*)g.Bt + (size_t)nxt.pn * tstep : cB;
        for (int t = 0; t < nt; t += 2) {
            const bool last = (t == nt - 2);
            const char* a1 = cA + (size_t)(t + 1) * kstep;
            const char* a2 = last ? nA : cA + (size_t)(t + 2) * kstep; const char* b2 = last ? nB : cB + (size_t)(t + 2) * kstep;
            const char* a3 = a2 + kstep; const char* b3 = b2 + kstep;
            if (last && has_next) S.a_ready(nxt);
            if constexpr (SP2) {
            PG8_LDB(B0, 0, 0); PG8_LDB(B1, 0, 1); PG8_SCHED; PG8_LDA(At, 0, 0); PG8_STAGE(PG8_SA(1, 1), a1 + hstep, voffA);
            PG8_WAIT_V(8); PG8_WAIT_L(0); PG8_BAR; PG8_MMA(0, 0, At, B0); PG8_MMA(0, 1, At, B1); PG8_BAR; PG8_SCHED;
            PG8_LDA(At, 0, 1); PG8_STAGE(PG8_SB(0, 0), b2, voffB); PG8_STAGE(PG8_SB(0, 1), b2 + hstep, voffB); PG8_STAGE(PG8_SA(0, 0), a2, voffA);
            PG8_WAIT_V(8); PG8_WAIT_L(0); PG8_BAR; PG8_MMA(1, 0, At, B0); PG8_MMA(1, 1, At, B1); PG8_BAR; PG8_SCHED;
            PG8_LDB(B0, 1, 0); PG8_LDB(B1, 1, 1); PG8_SCHED; PG8_LDA(At, 1, 0); PG8_STAGE(PG8_SA(0, 1), a2 + hstep, voffA);
            PG8_WAIT_V(8); PG8_WAIT_L(0); PG8_BAR; PG8_MMA(0, 0, At, B0); PG8_MMA(0, 1, At, B1); PG8_BAR; PG8_SCHED;
            PG8_LDA(At, 1, 1); PG8_STAGE(PG8_SB(1, 0), b3, voffB); PG8_STAGE(PG8_SB(1, 1), b3 + hstep, voffB); PG8_STAGE(PG8_SA(1, 0), a3, voffA);
            PG8_WAIT_V(8); PG8_WAIT_L(0); PG8_BAR; PG8_MMA(1, 0, At, B0); PG8_MMA(1, 1, At, B1); PG8_BAR; PG8_SCHED;
            } else {
            PG8_LDB(B0, 0, 0); PG8_SCHED; PG8_LDA(At, 0, 0); PG8_STAGE(PG8_SA(1, 1), a1 + hstep, voffA);
            PG8_WAIT_L(8); PG8_BAR; PG8_WAIT_L(0); PG8_MMA(0, 0, At, B0); PG8_BAR; PG8_SCHED;
            PG8_LDB(B1, 0, 1); PG8_STAGE(PG8_SB(0, 0), b2, voffB);
            PG8_BAR; PG8_WAIT_L(0); PG8_MMA(0, 1, At, B1); PG8_BAR;
            PG8_LDA(At, 0, 1); PG8_STAGE(PG8_SA(0, 0), a2, voffA);
            PG8_BAR; PG8_WAIT_L(0); PG8_MMA(1, 0, At, B0); PG8_BAR; PG8_SCHED;
            PG8_STAGE(PG8_SB(0, 1), b2 + hstep, voffB);
            PG8_WAIT_V(6); PG8_BAR; PG8_MMA(1, 1, At, B1); PG8_BAR;
            PG8_LDB(B0, 1, 0); PG8_SCHED; PG8_LDA(At, 1, 0); PG8_STAGE(PG8_SA(0, 1), a2 + hstep, voffA);
            PG8_WAIT_L(8); PG8_BAR; PG8_WAIT_L(0); PG8_MMA(0, 0, At, B0); PG8_BAR; PG8_SCHED;
            PG8_LDB(B1, 1, 1); PG8_STAGE(PG8_SB(1, 0), b3, voffB);
            PG8_BAR; PG8_WAIT_L(0); PG8_MMA(0, 1, At, B1); PG8_BAR;
            PG8_LDA(At, 1, 1); PG8_STAGE(PG8_SA(1, 0), a3, voffA);
            PG8_BAR; PG8_WAIT_L(0); PG8_MMA(1, 0, At, B0); PG8_BAR; PG8_SCHED;
            PG8_STAGE(PG8_SB(1, 1), b3 + hstep, voffB);
            PG8_WAIT_V(6); PG8_BAR; PG8_MMA(1, 1, At, B1); PG8_BAR;
            }
        }
        if constexpr (ALIGN_EPI) { if (wr == 0) PG8_BAR; }
        if constexpr (!Epi::AFTER_DRAIN) { E(acc, cur, wr, wc, fr, fq); S.done(cur); }
        if (!has_next) break;
#pragma unroll
        for (int a = 0; a < 2; ++a)
#pragma unroll
            for (int b = 0; b < 2; ++b)
#pragma unroll
                for (int m = 0; m < 4; ++m)
#pragma unroll
                    for (int n = 0; n < 2; ++n) acc[a][b][m][n] = (f32x4){0.f, 0.f, 0.f, 0.f};
        cur = nxt; cA = nA; cB = nB; ++ui;
        if constexpr (ALIGN_EPI) { if (wr == 1) PG8_BAR; }
    }
    PG8_WAIT_V(0);
    if constexpr (!ALIGN_EPI) { if (wr == 0) PG8_BAR; }
    PG8_BAR;
    if constexpr (Epi::AFTER_DRAIN) { E.fused(acc, cur, wr, wc, fr, fq, lds, wid, lane); S.done(cur); }
#undef PG8_SA
#undef PG8_SB
#undef PG8_STAGE
#undef PG8_LDA
#undef PG8_LDB
#undef PG8_MMA
#undef PG8_WAIT_V
#undef PG8_WAIT_L
#undef PG8_BAR
#undef PG8_SCHED
}
}

#ifndef MK_N_LAUNCHES
#define MK_N_LAUNCHES 1
#endif
#define LAS __attribute__((address_space(3)))
typedef pg8::bf16_t bf16_t;
typedef pg8::u32x4 u32x4;
typedef pg8::f32x4 f32x4;
typedef pg8::bf16x8 bf16x8;
typedef float f32x2 __attribute__((ext_vector_type(2)));
typedef float f32x16 __attribute__((ext_vector_type(16)));
typedef unsigned u32x2 __attribute__((ext_vector_type(2)));
using pg8::cvt_pk_bf16;

constexpr int NWAVES = 8;
constexpr int DM = 2048, NB = 4, SEQ = 2048, MTOK = NB * SEQ, NHEAD = 8, DSB = 1024, DCV = 1024, CWID = 31, DFF = 8192, DIN = 9216;
constexpr float EPS = 1e-6f;
constexpr size_t MiB = 1u << 20;
constexpr size_t WS_PSSQ = 1 * MiB;
constexpr size_t WS_H = 2 * MiB;
constexpr size_t WS_WIN = 34 * MiB;
constexpr size_t WS_WSB = 70 * MiB;
constexpr size_t WS_WO = 78 * MiB;
constexpr size_t WS_Q = 86 * MiB, WS_K = 102 * MiB, WS_VT = 118 * MiB;
constexpr size_t WS_U = 134 * MiB;
constexpr size_t WS_OA = 150 * MiB;
constexpr size_t WS_G = 182 * MiB;
constexpr size_t WS_MERGED = 86 * MiB;
constexpr size_t WS_Y = 182 * MiB;
constexpr size_t WS_WUP = 34 * MiB;
constexpr size_t WS_WDN = 66 * MiB;
constexpr size_t WS_F = 98 * MiB;
constexpr size_t WS_Y2 = 2 * MiB;
constexpr size_t WS_END = 246 * MiB;
constexpr int LDS_BYTES = 147456;

#define LDS_WAIT() asm volatile("s_waitcnt lgkmcnt(0)" ::: "memory")
__device__ __forceinline__ float wave_sum(float v) {
#pragma unroll
    for (int o = 1; o < 64; o <<= 1) v += __shfl_xor(v, o);
    return v;
}
__device__ __forceinline__ int win_row(int n) {
    if (n < 3072 || n >= 5120) return n;
    int c = n - 3072; const int isb = c >> 10; c &= 1023; return 3072 + (c >> 7) * 256 + isb * 128 + (c & 127);
}
template <bool WIN> __device__ __forceinline__ void transpose_item(const float* __restrict__ W, int K, int N, bf16_t* WT, LAS float* scr, int item, int lane) {
    const int nblk = N / 32, kb = item / nblk, nb = item % nblk, k0 = 64 * kb, n0 = 32 * nb;
    const int r0 = WIN ? win_row(n0) : n0;
#pragma unroll 8
    for (int i = 0; i < 32; ++i) { const int kk = 2 * i + (lane >> 5); scr[kk * 33 + (lane & 31)] = W[(size_t)(k0 + kk) * N + n0 + (lane & 31)]; }
    LDS_WAIT(); asm volatile("" ::: "memory");
    const int c = lane & 7;
#pragma unroll
    for (int j = 0; j < 4; ++j) { const int n = (lane >> 3) + 8 * j; const LAS float* s = scr + (8 * c) * 33 + n;
        u32x4 o; o.x = cvt_pk_bf16(s[0 * 33], s[1 * 33]); o.y = cvt_pk_bf16(s[2 * 33], s[3 * 33]); o.z = cvt_pk_bf16(s[4 * 33], s[5 * 33]); o.w = cvt_pk_bf16(s[6 * 33], s[7 * 33]);
        *(u32x4*)(WT + (size_t)(r0 + n) * K + k0 + 8 * c) = o; }
    LDS_WAIT(); asm volatile("" ::: "memory");
}
__device__ __forceinline__ void rms_row_bf16(const float* xrow, const float* g, bf16_t* orow, int lane) {
    const f32x4* xr = (const f32x4*)xrow + lane; f32x4 v[8]; float s = 0.f;
#pragma unroll
    for (int j = 0; j < 8; ++j) { v[j] = xr[64 * j]; s += (v[j].x * v[j].x + v[j].y * v[j].y) + (v[j].z * v[j].z + v[j].w * v[j].w); }
    const float rstd = 1.0f / sqrtf(wave_sum(s) * (1.0f / DM) + EPS);
    const f32x4* gr = (const f32x4*)g + lane; u32x2* o8 = (u32x2*)orow + lane;
#pragma unroll
    for (int j = 0; j < 8; ++j) { const f32x4 gv = gr[64 * j]; const f32x4 o = v[j] * rstd * gv; u32x2 w; w.x = cvt_pk_bf16(o.x, o.y); w.y = cvt_pk_bf16(o.z, o.w); o8[64 * j] = w; }
}
__device__ __forceinline__ void mid_row(const float* xrow, const float* yrow, const float* ps, const float* g1, const float* g2, float* orow, bf16_t* hrow, int lane) {
    const float p = lane < 32 ? ps[lane] : 0.f; const float rstd1 = 1.0f / sqrtf(wave_sum(p) * (1.0f / DM) + EPS);
    f32x4 v[8]; float s = 0.f;
#pragma unroll
    for (int j = 0; j < 8; ++j) { const f32x4 y = ((const f32x4*)yrow)[64 * j + lane], x = ((const f32x4*)xrow)[64 * j + lane], g = ((const f32x4*)g1)[64 * j + lane];
        v[j] = x + y * rstd1 * g; ((f32x4*)orow)[64 * j + lane] = v[j]; s += (v[j].x * v[j].x + v[j].y * v[j].y) + (v[j].z * v[j].z + v[j].w * v[j].w); }
    const float rstd2 = 1.0f / sqrtf(wave_sum(s) * (1.0f / DM) + EPS);
#pragma unroll
    for (int j = 0; j < 8; ++j) { const f32x4 g = ((const f32x4*)g2)[64 * j + lane]; const f32x4 o = v[j] * rstd2 * g; u32x2 w; w.x = cvt_pk_bf16(o.x, o.y); w.y = cvt_pk_bf16(o.z, o.w); ((u32x2*)hrow)[64 * j + lane] = w; }
}
__device__ __forceinline__ void fin_row(const float* frow, const float* ps, const float* g, float* orow, int lane) {
    const float p = lane < 32 ? ps[lane] : 0.f; const float rstd = 1.0f / sqrtf(wave_sum(p) * (1.0f / DM) + EPS);
#pragma unroll
    for (int j = 0; j < 8; ++j) { const f32x4 f = ((const f32x4*)frow)[64 * j + lane], x = ((const f32x4*)orow)[64 * j + lane], gv = ((const f32x4*)g)[64 * j + lane];
        ((f32x4*)orow)[64 * j + lane] = x + f * rstd * gv; }
}

template <int RR> __device__ __forceinline__ void conv_row(f32x2 (&acc)[32], const f32x2 (&w)[CWID], const LAS unsigned char* base, unsigned& pk) {
    const unsigned cur = pk; if (RR + 1 < 62) pk = *(const LAS unsigned*)(base + (RR + 1) * 2048);
    const f32x2 uv = {pg8::bf_lo(cur), pg8::bf_hi(cur)};
#pragma unroll
    for (int k = 0; k < CWID; ++k) { if (RR - k >= 0 && RR - k < 32) acc[(RR - k) & 31] = __builtin_elementwise_fma(uv, w[k], acc[(RR - k) & 31]); }
    __builtin_amdgcn_sched_barrier(0);
}
template <int... RR> __device__ __forceinline__ void conv_rows(std::integer_sequence<int, RR...>, f32x2 (&acc)[32], const f32x2 (&w)[CWID], const LAS unsigned char* base) {
    unsigned pk = *(const LAS unsigned*)(base); (conv_row<RR>(acc, w, base, pk), ...); }
__device__ __forceinline__ void conv_chunk(LAS unsigned char* lds, const bf16_t* __restrict__ U, const float* __restrict__ wdw, const float* __restrict__ bdw, const float* __restrict__ gln, const float* __restrict__ bln,
                                           bf16_t* __restrict__ U2, int chunk, int tid, int wave, int lane) {
    const int b = chunk >> 6, t0 = (chunk & 63) * 32;
    asm volatile("" : "+s"(wdw), "+s"(U));
#pragma unroll 4
    for (int i = 0; i < 16; ++i) { const int idx = tid + 512 * i; const int row = idx >> 7, c16 = idx & 127;
        if (row < 62) { const int t = t0 - 30 + row; u32x4 v = {0u, 0u, 0u, 0u}; if (t >= 0) v = *(const u32x4*)(U + ((size_t)(b * SEQ + t) * DCV + c16 * 8));
            *(LAS u32x4*)(lds + row * 2048 + c16 * 16) = v; } }
    __syncthreads();
    const int c = wave * 128 + 2 * lane;
    f32x2 w[CWID];
#pragma unroll
    for (int k = 0; k < CWID; ++k) w[k] = *(const f32x2*)(wdw + k * DCV + c);
    f32x2 acc[32]; const f32x2 bias = *(const f32x2*)(bdw + c);
#pragma unroll
    for (int tt = 0; tt < 32; ++tt) acc[tt] = bias;
    conv_rows(std::make_integer_sequence<int, 62>{}, acc, w, lds + c * 2);
    LAS f32x2* stat = (LAS f32x2*)(lds + 62 * 2048);
#pragma unroll
    for (int tt = 0; tt < 32; ++tt) { const float mw = wave_sum(acc[tt].x + acc[tt].y) * (1.0f / 128.0f); const float dx = acc[tt].x - mw, dy = acc[tt].y - mw;
        const float q = wave_sum(dx * dx + dy * dy); if (lane == 0) stat[tt * 8 + wave] = (f32x2){mw, q}; }
    __syncthreads();
    float mean_l, rstd_l;
    { const int tt = lane & 31; float ms = 0.f; f32x2 pr[8];
#pragma unroll
        for (int k = 0; k < 8; ++k) { pr[k] = stat[tt * 8 + k]; ms += pr[k].x; }
        const float mean = ms * 0.125f; float m2 = 0.f;
#pragma unroll
        for (int k = 0; k < 8; ++k) { const float d = pr[k].x - mean; m2 += pr[k].y + 128.0f * d * d; }
        mean_l = mean; rstd_l = 1.0f / sqrtf(m2 * (1.0f / DCV) + EPS); }
    const f32x2 gv = *(const f32x2*)(gln + c), bv = *(const f32x2*)(bln + c);
#pragma unroll
    for (int tt = 0; tt < 32; ++tt) { const float mean = __builtin_bit_cast(float, __builtin_amdgcn_readlane(__builtin_bit_cast(int, mean_l), tt)), rstd = __builtin_bit_cast(float, __builtin_amdgcn_readlane(__builtin_bit_cast(int, rstd_l), tt));
        const float y0 = (acc[tt].x - mean) * rstd * gv.x + bv.x, y1 = (acc[tt].y - mean) * rstd * gv.y + bv.y;
        *(unsigned*)(U2 + ((size_t)(b * SEQ + t0 + tt) * DCV + c)) = cvt_pk_bf16(y0 * pg8::sigm(y0), y1 * pg8::sigm(y1)); }
    __syncthreads();
}

__device__ __forceinline__ int crow(int r, int hi) { return (r & 3) + 8 * (r >> 2) + 4 * hi; }
__device__ __forceinline__ void attn_wave_unit(const bf16_t* __restrict__ Qp, const bf16_t* __restrict__ Kp, const bf16_t* __restrict__ Vt, bf16_t* __restrict__ O, int bh, int qb, int lane) {
    const int ql = lane & 31, hi = lane >> 5; const int fo = (ql * 2 + hi) * 8;
    const bf16_t* qsrc = Qp + ((size_t)(bh * 64 + qb) << 12) + fo;
    const bf16_t* kbase = Kp + ((size_t)(bh * 64) << 12) + fo; const bf16_t* vbase = Vt + ((size_t)(bh * 64) << 12) + fo;
    bf16x8 qf[8], kf[8];
#pragma unroll
    for (int s = 0; s < 8; ++s) { qf[s] = *(const bf16x8*)(qsrc + s * 512); kf[s] = *(const bf16x8*)(kbase + ((size_t)qb << 12) + s * 512); }
    f32x16 o[4];
#pragma unroll
    for (int d = 0; d < 4; ++d)
#pragma unroll
        for (int i = 0; i < 16; ++i) o[d][i] = 0.f;
    float carry = 1.0f;
    for (int kb = qb; kb >= 0; --kb) {
        const int kn_ = kb > 0 ? kb - 1 : 0;
        bf16x8 vf[8];
#pragma unroll
        for (int s = 0; s < 8; ++s) vf[s] = *(const bf16x8*)(vbase + ((size_t)kb << 12) + s * 512);
        f32x16 p;
#pragma unroll
        for (int i = 0; i < 16; ++i) p[i] = 0.f;
#pragma unroll
        for (int s = 0; s < 8; ++s) p = __builtin_amdgcn_mfma_f32_32x32x16_bf16(kf[s], qf[s], p, 0, 0, 0);
#pragma unroll
        for (int s = 0; s < 8; ++s) kf[s] = *(const bf16x8*)(kbase + ((size_t)kn_ << 12) + s * 512);
        float E[16], r[16];
#pragma unroll
        for (int i = 0; i < 16; ++i) E[i] = __builtin_amdgcn_exp2f(fminf(p[i], 100.0f));
        if (kb == qb) {
#pragma unroll
            for (int i = 0; i < 16; ++i) if (crow(i, hi) >= ql) E[i] = 0.f;
        }
#pragma unroll
        for (int i = 0; i < 16; ++i) r[i] = __builtin_amdgcn_rcpf(1.0f + E[i]);
        float W[4], part[4];
#pragma unroll
        for (int g = 0; g < 4; ++g) { r[4 * g + 2] *= r[4 * g + 3]; r[4 * g + 1] *= r[4 * g + 2]; r[4 * g] *= r[4 * g + 1]; part[g] = __shfl_xor(r[4 * g], 32); W[g] = r[4 * g] * part[g]; }
        float S[4]; S[3] = carry; S[2] = S[3] * W[3]; S[1] = S[2] * W[2]; S[0] = S[1] * W[1]; carry = S[0] * W[0];
        u32x4 pw[2];
#pragma unroll
        for (int g = 0; g < 4; ++g) { const float off = hi ? S[g] : S[g] * part[g];
            const float a0 = E[4 * g] * (r[4 * g] * off), a1 = E[4 * g + 1] * (r[4 * g + 1] * off), a2 = E[4 * g + 2] * (r[4 * g + 2] * off), a3 = E[4 * g + 3] * (r[4 * g + 3] * off);
            pw[g >> 1][2 * (g & 1)] = cvt_pk_bf16(a0, a1); pw[g >> 1][2 * (g & 1) + 1] = cvt_pk_bf16(a2, a3); }
#pragma unroll
        for (int d = 0; d < 4; ++d)
#pragma unroll
            for (int s = 0; s < 2; ++s) o[d] = __builtin_amdgcn_mfma_f32_32x32x16_bf16(vf[d * 2 + s], __builtin_bit_cast(bf16x8, pw[s]), o[d], 0, 0, 0);
        if (__builtin_amdgcn_ballot_w64(carry != 0.0f) == 0ull) break;
    }
    const int b = bh >> 3, h = bh & 7;
    bf16_t* orow = O + ((size_t)(b * SEQ + qb * 32 + ql) * DSB + h * 128 + 4 * hi);
#pragma unroll
    for (int d = 0; d < 4; ++d)
#pragma unroll
        for (int g = 0; g < 4; ++g) { u32x2 w; w.x = cvt_pk_bf16(o[d][4 * g], o[d][4 * g + 1]); w.y = cvt_pk_bf16(o[d][4 * g + 2], o[d][4 * g + 3]); *(u32x2*)(orow + 32 * d + 8 * g) = w; }
}

struct Args { const float* in[16]; float* out; unsigned char* ws; int ph_lo, ph_hi; };
__global__ void __launch_bounds__(NWAVES * 64, 2) mega_fwd(Args args) {
    extern __shared__ __attribute__((aligned(16))) unsigned char lds_raw[];
    LAS unsigned char* lds = (LAS unsigned char*)lds_raw;
    const int tid = threadIdx.x, lane = tid & 63, wave = __builtin_amdgcn_readfirstlane(tid >> 6);
    const int G = gridDim.x, bx = blockIdx.x;
    const int gw = bx * NWAVES + wave, NGW = G * NWAVES;
    unsigned char* ws = args.ws;
    const float* x = args.in[0]; const float* g_pre_mix = args.in[1]; const float* w_in = args.in[2]; const float* b_in = args.in[3]; const float* w_dw = args.in[4]; const float* b_dw = args.in[5];
    const float* g_cln = args.in[6]; const float* b_cln = args.in[7]; const float* w_sb = args.in[8]; const float* w_cv = args.in[9]; const float* w_o = args.in[10]; const float* g_post_mix = args.in[11];
    const float* g_pre_mlp = args.in[12]; const float* w_up = args.in[13]; const float* w_dn = args.in[14]; const float* g_post_mlp = args.in[15];
    float* out = args.out;
    const int lo = args.ph_lo, hi = args.ph_hi;
#ifndef PH_MASK
#define PH_MASK 0x1ff
#endif
#define IN(k) (((PH_MASK >> (k)) & 1) && lo <= (k) && (k) < hi)
#if MK_N_LAUNCHES == 1
#define SEAM(k) do { if (IN(k) && IN((k) + 1)) { cg::this_grid().sync(); } } while (0)
#else
#define SEAM(k) do { } while (0)
#endif
    LAS float* scr = (LAS float*)(lds + wave * 16384);

    if (IN(0)) {
        constexpr int I_IN = (DM / 64) * (DIN / 32), I_SB = (DSB / 64) * (DM / 32), I_O = (DM / 64) * (DM / 32);
        for (int it = gw; it < I_IN + 2 * I_SB + I_O; it += NGW) {
            int r = it;
            if (r < I_IN) { transpose_item<true>(w_in, DM, DIN, (bf16_t*)(ws + WS_WIN), scr, r, lane); continue; } r -= I_IN;
            if (r < I_SB) { transpose_item<false>(w_sb, DSB, DM, (bf16_t*)(ws + WS_WSB), scr, r, lane); continue; } r -= I_SB;
            if (r < I_SB) { transpose_item<false>(w_cv, DCV, DM, (bf16_t*)(ws + WS_WSB) + (size_t)DM * DSB, scr, r, lane); continue; } r -= I_SB;
            transpose_item<false>(w_o, DM, DM, (bf16_t*)(ws + WS_WO), scr, r, lane);
        }
        for (int m = gw; m < MTOK; m += NGW) rms_row_bf16(x + (size_t)m * DM, g_pre_mix, (bf16_t*)(ws + WS_H) + (size_t)m * DM, lane);
        __syncthreads();
    }
    SEAM(0);
    if (IN(1)) {
        pg8::Gemm g{(const bf16_t*)(ws + WS_H), (const bf16_t*)(ws + WS_WIN), MTOK, DIN, DM}; pg8::StaticOrder S; S.init(MTOK, DIN, G, bx);
        pg8::EpiProj E{(bf16_t*)(ws + WS_Q), (bf16_t*)(ws + WS_K), (bf16_t*)(ws + WS_VT), (bf16_t*)(ws + WS_U), (bf16_t*)(ws + WS_G), b_in};
        pg8::gemm_phase<pg8::EpiProj, pg8::StaticOrder, true, true>(lds, g, S, E);
    }
    SEAM(1);
    if (IN(2)) {
        for (int ch = bx; ch < MTOK / 32; ch += G)
            conv_chunk(lds, (const bf16_t*)(ws + WS_U), w_dw, b_dw, g_cln, b_cln, (bf16_t*)(ws + WS_OA) + (size_t)MTOK * DSB, ch, tid, wave, lane);
        for (int vc = bx; vc < 256; vc += G) {
            const int bh = vc >> 3, gq = vc & 7; const int qb = wave < 4 ? 8 * wave + gq : 63 - (8 * (wave - 4) + gq);
            attn_wave_unit((const bf16_t*)(ws + WS_Q), (const bf16_t*)(ws + WS_K), (const bf16_t*)(ws + WS_VT), (bf16_t*)(ws + WS_OA), bh, qb, lane);
        }
        __syncthreads();
    }
    SEAM(2);
    if (IN(3)) {
        pg8::Gemm g{(const bf16_t*)(ws + WS_OA), (const bf16_t*)(ws + WS_WSB), 2 * MTOK, 2 * DM, DSB}; pg8::DualOrder S; S.init(G, bx);
        pg8::EpiDual E{(const bf16_t*)(ws + WS_G), out, (bf16_t*)(ws + WS_MERGED)};
        pg8::gemm_phase<pg8::EpiDual, pg8::DualOrder, true, true>(lds, g, S, E);
    }
    SEAM(3);
    if (IN(4)) {
        pg8::Gemm g{(const bf16_t*)(ws + WS_MERGED), (const bf16_t*)(ws + WS_WO), MTOK, DM, DM}; pg8::StaticOrder S; S.init(MTOK, DM, G, bx);
        pg8::EpiY E{(float*)(ws + WS_Y), (float*)(ws + WS_PSSQ)};
        pg8::gemm_phase<pg8::EpiY, pg8::StaticOrder, true, true>(lds, g, S, E);
    }
    SEAM(4);
    if (IN(5)) {
        for (int m = gw; m < MTOK; m += NGW)
            mid_row(x + (size_t)m * DM, (const float*)(ws + WS_Y) + (size_t)m * DM, (const float*)(ws + WS_PSSQ) + (size_t)m * 32, g_post_mix, g_pre_mlp, out + (size_t)m * DM, (bf16_t*)(ws + WS_H) + (size_t)m * DM, lane);
        constexpr int I_UP = (DM / 64) * (DFF / 32), I_DN = (DFF / 64) * (DM / 32);
        for (int it = gw; it < I_UP + I_DN; it += NGW) {
            if (it < I_UP) transpose_item<false>(w_up, DM, DFF, (bf16_t*)(ws + WS_WUP), scr, it, lane);
            else transpose_item<false>(w_dn, DFF, DM, (bf16_t*)(ws + WS_WDN), scr, it - I_UP, lane);
        }
        __syncthreads();
    }
    SEAM(5);
    if (IN(6)) {
        pg8::Gemm g{(const bf16_t*)(ws + WS_H), (const bf16_t*)(ws + WS_WUP), MTOK, DFF, DM}; pg8::StaticOrder S; S.init(MTOK, DFF, G, bx);
        pg8::EpiUp E{(bf16_t*)(ws + WS_F)};
        pg8::gemm_phase<pg8::EpiUp, pg8::StaticOrder, true, true>(lds, g, S, E);
    }
    SEAM(6);
    if (IN(7)) {
        pg8::Gemm g{(const bf16_t*)(ws + WS_F), (const bf16_t*)(ws + WS_WDN), MTOK, DM, DFF}; pg8::StaticOrder S; S.init(MTOK, DM, G, bx);
        pg8::EpiY E{(float*)(ws + WS_Y2), (float*)(ws + WS_PSSQ)};
        pg8::gemm_phase<pg8::EpiY, pg8::StaticOrder, true, true>(lds, g, S, E);
    }
    SEAM(7);
    if (IN(8)) {
        for (int m = gw; m < MTOK; m += NGW)
            fin_row((const float*)(ws + WS_Y2) + (size_t)m * DM, (const float*)(ws + WS_PSSQ) + (size_t)m * 32, g_post_mlp, out + (size_t)m * DM, lane);
    }
#undef IN
#undef SEAM
}

extern "C" void kernel_launch(void* const* d_in, const int* in_sizes, int n_in, void* d_out, int out_size, void* d_ws, size_t ws_size, hipStream_t stream) {
    static int grid = 0;
    if (grid == 0) {
        if (n_in != 16 || in_sizes[0] != MTOK * DM || out_size != MTOK * DM || ws_size < WS_END) { fprintf(stderr, "kernel_launch: unexpected shapes / workspace (%d inputs, ws %zu)\n", n_in, ws_size); grid = -1; return; }
        int dev = 0, cus = 0, per_cu = 0;
        (void)hipGetDevice(&dev); (void)hipDeviceGetAttribute(&cus, hipDeviceAttributeMultiprocessorCount, dev);
        if (hipFuncSetAttribute((const void*)mega_fwd, hipFuncAttributeMaxDynamicSharedMemorySize, LDS_BYTES) != hipSuccess) { fprintf(stderr, "kernel_launch: hipFuncSetAttribute failed\n"); grid = -1; return; }
        if (hipOccupancyMaxActiveBlocksPerMultiprocessor(&per_cu, (const void*)mega_fwd, NWAVES * 64, LDS_BYTES) != hipSuccess || per_cu < 1) { fprintf(stderr, "kernel_launch: occupancy query says %d\n", per_cu); per_cu = 1; }
        (void)hipGetLastError();
        grid = cus > 0 ? cus : 256;
    }
    if (grid < 0) return;
    Args a{};
    for (int i = 0; i < 16; ++i) a.in[i] = (const float*)d_in[i];
    a.out = (float*)d_out; a.ws = (unsigned char*)d_ws;
#if MK_N_LAUNCHES == 1
    a.ph_lo = 0; a.ph_hi = 9;
    void* kargs[] = {&a};
    hipError_t e = hipLaunchCooperativeKernel((const void*)mega_fwd, dim3(grid), dim3(NWAVES * 64), kargs, LDS_BYTES, stream);
    if (e != hipSuccess) fprintf(stderr, "kernel_launch: cooperative launch failed: %s (grid %d)\n", hipGetErrorString(e), grid);
#else
    for (int ph = 0; ph < 9; ++ph) { a.ph_lo = ph; a.ph_hi = ph + 1; hipLaunchKernelGGL(mega_fwd, dim3(grid), dim3(NWAVES * 64), LDS_BYTES, stream, a); }
#endif
}
```
